# Optimizing an MI355X kernel written in HIP

```python
import jax, jax.numpy as jnp
from jax import lax
import numpy as np

D_MODEL = 1024
BATCH = 8
SEQ = 2048
DEPTH = 1
DEC_BATCH = 128
DEC_SEQ = 1
PAST_LEN = 16384
PAGE_SIZE = 128

N_META = 16
POOL_WINDOWS = (2, 4, 8, 16)
N_POOL_GROUPS = len(POOL_WINDOWS)
POOL_WIDTH = D_MODEL // 2
POOL_GC = POOL_WIDTH // N_POOL_GROUPS
POOL_OUT_GC = D_MODEL // N_POOL_GROUPS
POOL_BUF = max(POOL_WINDOWS) - 1
CONV_WIDTH = D_MODEL // 2
CONV_W = 3
D_FF = 2816
EPS = 1e-6
IN_SIZES = (POOL_WIDTH, CONV_WIDTH, CONV_WIDTH, CONV_WIDTH, D_MODEL, D_MODEL)
IN_SPLITS = tuple(int(s) for s in np.cumsum(IN_SIZES)[:-1])
IN_TOTAL = int(sum(IN_SIZES))

kernel_name = "pool_shortconv_gated_hybrid_step"


def rmsnorm(x, g):
    xf = x.astype(jnp.float32)
    y = xf * lax.rsqrt(jnp.mean(xf * xf, axis=-1, keepdims=True) + EPS)
    return (y * g.astype(jnp.float32)).astype(x.dtype)


def causal_dwconv(x, buf, w):
    T = x.shape[1]
    xp = jnp.concatenate([buf.astype(x.dtype), x], axis=1)
    y = xp[:, 0:T] * w[0]
    for k in range(1, CONV_W):
        y = y + xp[:, k:k + T] * w[k]
    return y, xp[:, T:]


def multiscale_pool(u, buf, pos0, w_pool, scale):
    B, T, _ = u.shape
    up = jnp.concatenate([buf.astype(u.dtype), u], axis=1)
    cs = jnp.cumsum(up.astype(jnp.float32), axis=1)
    cs = jnp.pad(cs, ((0, 0), (1, 0), (0, 0)))
    hi = cs[:, POOL_BUF + 1:POOL_BUF + 1 + T]
    pos = (pos0 + jnp.arange(T)).astype(jnp.int32)
    uf = u.astype(jnp.float32)
    outs = []
    for g, w in enumerate(POOL_WINDOWS):
        sl = slice(g * POOL_GC, (g + 1) * POOL_GC)
        lo = cs[:, POOL_BUF + 1 - w:POOL_BUF + 1 - w + T, sl]
        cnt = jnp.minimum(w, pos + 1).astype(jnp.float32)[None, :, None]
        outs.append((hi[..., sl] - lo) / cnt - uf[..., sl])
    pooled = jnp.stack(outs, axis=2).astype(u.dtype)
    mixed = jnp.einsum('btgc,gco->btgo', pooled, w_pool).reshape(B, T, D_MODEL)
    return mixed * scale, up[:, T:]


def trunk_layer(x, pos0, buf_pool, buf_conv, buf_ffn, w_in, w_pool, pool_scale, w_conv,
                w_conv_out, w_o, w_up, w_ffn_conv, w_down, g_pre_mix, g_post_mix,
                g_pre_ffn, g_post_ffn):
    h = rmsnorm(x, g_pre_mix)
    z = h @ w_in
    u, v, bg, cg, ga, gb = jnp.split(z, IN_SPLITS, axis=-1)
    a, new_pool = multiscale_pool(u, buf_pool, pos0, w_pool, pool_scale)
    cv, new_conv = causal_dwconv(cg * v, buf_conv, w_conv)
    b = (bg * cv) @ w_conv_out
    merged = jax.nn.sigmoid(ga) * a + jax.nn.sigmoid(gb) * b
    x = x + rmsnorm(merged @ w_o, g_post_mix)
    h = rmsnorm(x, g_pre_ffn)
    upc, new_ffn = causal_dwconv(h @ w_up, buf_ffn, w_ffn_conv)
    gate, val = jnp.split(upc, 2, axis=-1)
    y = (jax.nn.silu(gate) * val) @ w_down
    x = x + rmsnorm(y, g_post_ffn)
    return x, new_pool, new_conv, new_ffn


def setup_inputs(seed: int = 0) -> dict:
    key = jax.random.key(seed)
    ks = jax.random.split(key, 20)
    f32 = jnp.float32
    nrm = lambda k, shape, s: jax.random.normal(k, shape, f32) * s
    return {
        "x_prompt": nrm(ks[0], (BATCH, SEQ, D_MODEL), 1.0),
        "x_sample": nrm(ks[1], (DEC_BATCH, DEC_SEQ, D_MODEL), 1.0),
        "state_pool": nrm(ks[2], (DEPTH, DEC_BATCH, POOL_BUF, POOL_WIDTH), 1.0),
        "state_conv": nrm(ks[3], (DEPTH, DEC_BATCH, CONV_W - 1, CONV_WIDTH), 1.0),
        "state_ffn": nrm(ks[4], (DEPTH, DEC_BATCH, CONV_W - 1, 2 * D_FF), 1.0),
        "meta_tokens": nrm(ks[5], (N_META, D_MODEL), 1.0),
        "w_in": nrm(ks[6], (DEPTH, D_MODEL, IN_TOTAL), D_MODEL ** -0.5),
        "w_pool": nrm(ks[7], (DEPTH, N_POOL_GROUPS, POOL_GC, POOL_OUT_GC), POOL_GC ** -0.5),
        "pool_scale": 1.0 + nrm(ks[8], (DEPTH, D_MODEL), 0.05),
        "w_conv": nrm(ks[9], (DEPTH, CONV_W, CONV_WIDTH), CONV_W ** -0.5),
        "w_conv_out": nrm(ks[10], (DEPTH, CONV_WIDTH, D_MODEL), CONV_WIDTH ** -0.5),
        "w_o": nrm(ks[11], (DEPTH, D_MODEL, D_MODEL), D_MODEL ** -0.5),
        "w_up": nrm(ks[12], (DEPTH, D_MODEL, 2 * D_FF), D_MODEL ** -0.5),
        "w_ffn_conv": nrm(ks[13], (DEPTH, CONV_W, 2 * D_FF), CONV_W ** -0.5),
        "w_down": nrm(ks[14], (DEPTH, D_FF, D_MODEL), D_FF ** -0.5),
        "g_pre_mix": 1.0 + nrm(ks[15], (DEPTH, D_MODEL), 0.05),
        "g_post_mix": 1.0 + nrm(ks[16], (DEPTH, D_MODEL), 0.05),
        "g_pre_ffn": 1.0 + nrm(ks[17], (DEPTH, D_MODEL), 0.05),
        "g_post_ffn": 1.0 + nrm(ks[18], (DEPTH, D_MODEL), 0.05),
    }


def reference(x_prompt, x_sample, state_pool, state_conv, state_ffn, meta_tokens, w_in, w_pool,
              pool_scale, w_conv, w_conv_out, w_o, w_up, w_ffn_conv, w_down, g_pre_mix,
              g_post_mix, g_pre_ffn, g_post_ffn):
    meta = jnp.broadcast_to(meta_tokens.astype(x_prompt.dtype)[None], (BATCH, N_META, D_MODEL))
    xp = jnp.concatenate([meta, x_prompt], axis=1)
    xs = x_sample
    zp_pool = jnp.zeros((BATCH, POOL_BUF, POOL_WIDTH), xp.dtype)
    zp_conv = jnp.zeros((BATCH, CONV_W - 1, CONV_WIDTH), xp.dtype)
    zp_ffn = jnp.zeros((BATCH, CONV_W - 1, 2 * D_FF), xp.dtype)
    pp, pc, pf, sp, sc, sf = [], [], [], [], [], []
    for l in range(DEPTH):
        params = (w_in[l], w_pool[l], pool_scale[l], w_conv[l], w_conv_out[l], w_o[l], w_up[l],
                  w_ffn_conv[l], w_down[l], g_pre_mix[l], g_post_mix[l], g_pre_ffn[l],
                  g_post_ffn[l])
        xp, np_, nc_, nf_ = trunk_layer(xp, 0, zp_pool, zp_conv, zp_ffn, *params)
        pp.append(np_); pc.append(nc_); pf.append(nf_)
        xs, ns_p, ns_c, ns_f = trunk_layer(xs, PAST_LEN, state_pool[l], state_conv[l],
                                           state_ffn[l], *params)
        sp.append(ns_p); sc.append(ns_c); sf.append(ns_f)
    y_prompt = xp[:, N_META:]
    y_sample = xs
    return (y_prompt, y_sample, jnp.stack(pp), jnp.stack(pc), jnp.stack(pf),
            jnp.stack(sp), jnp.stack(sc), jnp.stack(sf))
```

```cpp
#include <hip/hip_runtime.h>
#include <cstdio>
#include <cstdint>

#define LAS __attribute__((address_space(3)))
#define GAS __attribute__((address_space(1)))
typedef unsigned short bf16_t;
typedef short bf16x8 __attribute__((ext_vector_type(8)));
typedef float f32x4 __attribute__((ext_vector_type(4)));
typedef float f32x2 __attribute__((ext_vector_type(2)));
typedef unsigned u32x4 __attribute__((ext_vector_type(4)));
typedef unsigned u32x2 __attribute__((ext_vector_type(2)));

constexpr int D = 1024, SEQ = 2048, NB = 8, NMETA = 16, DEC = 128, PW = 512, CW = 512, DFF = 2816, NUP = 5632, NIN = 4096;
constexpr int R_SAMP = 16384, R_META = 16512, R_PAD = 16528, M = 16640, NTILE = M / 256;
constexpr float EPS = 1e-6f;
constexpr size_t O_YP = 0, O_YS = 16777216, O_NSPP = 16908288, O_NSCP = 16969728, O_NSFP = 16977920, O_NSPS = 17068032, O_NSCS = 18051072, O_NSFS = 18182144;
constexpr size_t MiB = 1u << 20;
constexpr size_t WS_CTL = 0, CTL_ZERO_BYTES = 1 * MiB;
constexpr size_t WS_WIN = 2 * MiB, WS_WP = 10 * MiB, WS_WCO = 10 * MiB + 512 * 1024, WS_WO = 12 * MiB, WS_WUP = 14 * MiB, WS_WD = 25 * MiB, WS_WFC = 31 * MiB;
constexpr size_t WS_HB = 32 * MiB;
constexpr size_t SZ_512 = (size_t)M * 512 * 2, SZ_1024 = (size_t)M * 1024 * 2;
constexpr size_t WS_U = 66 * MiB, WS_P = WS_U + SZ_512, WS_BG = WS_P + SZ_512, WS_POOLED = WS_BG + SZ_512, WS_BGCV = WS_POOLED + SZ_512, WS_SA = WS_BGCV + SZ_512, WS_SB = WS_SA + SZ_1024;
constexpr size_t WS_O = 66 * MiB;
constexpr size_t WS_X1R = 213 * MiB;
constexpr size_t WS_ACT = 66 * MiB;
constexpr size_t WS_HALO = 156 * MiB;
constexpr size_t WS_UPR = 168 * MiB;
constexpr size_t WS_Y = 176 * MiB;
constexpr size_t WS_END = 256 * MiB;
static_assert(WS_SB + SZ_1024 <= WS_X1R && WS_ACT + (size_t)M * DFF * 2 <= WS_HALO && WS_HALO + 130ull * 4 * NUP * 4 <= WS_UPR && WS_UPR + 256ull * NUP * 4 <= WS_Y && WS_Y + (size_t)M * D * 4 <= WS_END, "ws map");
static_assert(WS_O + (size_t)M * D * 4 <= WS_BGCV, "O overlays only dead buffers");
constexpr int CW_TMO = 0, CW_BAR = 4096;

constexpr int NWAVES = 8;
constexpr int RING_BYTES = 131072, LDSCTL_OFF = RING_BYTES, MISC_OFF = LDSCTL_OFF + 320, LDS_BYTES = 147456;

__device__ __forceinline__ unsigned cvt_pk_bf16(float lo, float hi) { unsigned r; asm volatile("v_cvt_pk_bf16_f32 %0, %1, %2" : "=v"(r) : "v"(lo), "v"(hi)); return r; }
__device__ __forceinline__ float bf_lo(unsigned w) { return __uint_as_float(w << 16); }
__device__ __forceinline__ float bf_hi(unsigned w) { return __uint_as_float(w & 0xffff0000u); }
__device__ __forceinline__ float sigmoidf_(float x) { return __builtin_amdgcn_rcpf(1.0f + __builtin_amdgcn_exp2f(-1.4426950408889634f * x)); }
__device__ __forceinline__ u32x4 pack8(f32x4 a, f32x4 b) { u32x4 w; w.x = cvt_pk_bf16(a[0], a[1]); w.y = cvt_pk_bf16(a[2], a[3]); w.z = cvt_pk_bf16(b[0], b[1]); w.w = cvt_pk_bf16(b[2], b[3]); return w; }
__device__ __forceinline__ void unpack8(u32x4 w, f32x4& a, f32x4& b) { a = (f32x4){bf_lo(w.x), bf_hi(w.x), bf_lo(w.y), bf_hi(w.y)}; b = (f32x4){bf_lo(w.z), bf_hi(w.z), bf_lo(w.w), bf_hi(w.w)}; }
__device__ __forceinline__ float wave_sum(float v) {
#pragma unroll
    for (int o = 1; o < 64; o <<= 1) v += __shfl_xor(v, o);
    return v;
}
#define LDS_WAIT() asm volatile("s_waitcnt lgkmcnt(0)" ::: "memory")
#define VM_WAIT() asm volatile("s_waitcnt vmcnt(0)" ::: "memory")

#define XB_TMO      128
#define XB_XCNT(j)  (256  + 64 * (j))
#define XB_XSUB(j)  (1280 + 64 * (j))
#define XB_XGEN(j)  (2304 + 64 * (j))
#define XB_TOP      3328
#define XB_TOPGEN   3392
#define XCD_BAR_WORDS 3456
#define XB_SPIN_CAP (1u << 22)
__device__ __forceinline__ unsigned xb_ld(unsigned* p)              { return __hip_atomic_load(p, __ATOMIC_RELAXED, __HIP_MEMORY_SCOPE_AGENT); }
__device__ __forceinline__ unsigned xb_add(unsigned* p, unsigned v) { return __hip_atomic_fetch_add(p, v, __ATOMIC_RELAXED, __HIP_MEMORY_SCOPE_AGENT); }
__device__ __forceinline__ unsigned xb_xcc_id() { return (unsigned)__builtin_amdgcn_s_getreg((3 << 11) | 20) & 0xFu; }
#define XB_SPIN(cond, bar) do { unsigned _sp = 0; while (cond) { __builtin_amdgcn_s_sleep(1); \
    if ((++_sp & 255u) == 0u) { if (xb_ld(&(bar)[XB_TMO])) break; if (_sp > XB_SPIN_CAP) { atomicAdd(&(bar)[XB_TMO], 1u); break; } } } } while (0)
struct XcdBarrier { unsigned* bar; unsigned x; volatile LAS unsigned* st; };
__device__ __forceinline__ XcdBarrier xcd_barrier_post(unsigned* bar, volatile LAS unsigned* st) {
    XcdBarrier b; b.bar = bar; b.x = xb_xcc_id(); b.st = st;
    if (threadIdx.x == 0) (void)xb_add(&bar[XB_XCNT(b.x)], 1u);
    return b;
}
__device__ __forceinline__ void xcd_barrier_complete(unsigned* bar, unsigned x, unsigned& nloc, unsigned& nx) {
    const unsigned G = gridDim.x * gridDim.y * gridDim.z;
    unsigned sum, cnt, mine, sp = 0u;
    for (;;) {
        sum = 0u; cnt = 0u; mine = 0u;
#pragma unroll
        for (unsigned j = 0; j < 16; ++j) { const unsigned c = xb_ld(&bar[XB_XCNT(j)]); sum += c; cnt += (c > 0u) ? 1u : 0u; mine = (j == x) ? c : mine; }
        if (sum == G) break;
        __builtin_amdgcn_s_sleep(1);
        if ((++sp & 255u) == 0u) { if (xb_ld(&bar[XB_TMO])) break; if (sp > XB_SPIN_CAP) { atomicAdd(&bar[XB_TMO], 1u); break; } }
    }
    nloc = mine > 0u ? mine : 1u; nx = cnt > 0u ? cnt : 1u;
}
__device__ __forceinline__ void xcd_barrier(const XcdBarrier& b) {
    asm volatile("s_waitcnt vmcnt(0)" ::: "memory");
    __syncthreads();
    if (threadIdx.x == 0) {
        unsigned* bar = b.bar;
        __builtin_amdgcn_s_waitcnt(0);
        unsigned nloc = b.st[0], nx = b.st[1];
        if (nloc == 0u) { xcd_barrier_complete(bar, b.x, nloc, nx); b.st[0] = nloc; b.st[1] = nx; }
        const unsigned old = xb_add(&bar[XB_XSUB(b.x)], 1u);
        const unsigned gen = old / nloc;
        if (old + 1u == (gen + 1u) * nloc) {
            __builtin_amdgcn_fence(__ATOMIC_RELEASE, "agent");
            asm volatile("s_waitcnt vmcnt(0)" ::: "memory");
            const unsigned og = xb_add(&bar[XB_TOP], 1u);
            const unsigned tg = og / nx;
            if (og + 1u == (tg + 1u) * nx) xb_add(&bar[XB_TOPGEN], 1u);
            else XB_SPIN(xb_ld(&bar[XB_TOPGEN]) == tg, bar);
            __builtin_amdgcn_fence(__ATOMIC_ACQUIRE, "agent");
            xb_add(&bar[XB_XGEN(b.x)], 1u);
            asm volatile("s_waitcnt vmcnt(0)" ::: "memory");
        } else {
            XB_SPIN(xb_ld(&bar[XB_XGEN(b.x)]) == gen, bar);
            __builtin_amdgcn_fence(__ATOMIC_ACQUIRE, "agent");
            asm volatile("s_waitcnt vmcnt(0)" ::: "memory");
        }
    }
    __syncthreads();
}

namespace pg8 {
constexpr int BM = 256, BK = 64, HALF = 128, HTB = HALF * BK * 2, NXCD = 8, WGM = 8;
__host__ __device__ __forceinline__ int lds_byte(int r, int c) { const int st = (r >> 4) * 2 + (c >> 5), rr = r & 15, cc = c & 31, ob = rr * 64 + cc * 2; return st * 1024 + (ob ^ (((ob >> 9) & 1) << 5)); }
__host__ __device__ __forceinline__ void stage_rc(int b, int& R, int& C) { const int st = b / 1024, sb = b % 1024, swz = sb ^ (((sb >> 9) & 1) << 5); R = (st >> 1) * 16 + swz / 64; C = (st & 1) * 32 + (swz % 64) / 2; }
__host__ __device__ __forceinline__ int perm32(int rho) { const int n = rho >> 4, i = rho & 15; return 8 * (i >> 2) + 4 * n + (i & 3); }

struct Unit { int pm, pn; };
struct Gemm { const bf16_t* A; const bf16_t* Bt; int lda, K, nM, nN, a_pn_off; };

struct StaticOrder {
    int nM, nN, nwg, G, c;
    __device__ void init(int nM_, int nN_, int G_, int c_) { nM = nM_; nN = nN_; nwg = nM * nN; G = G_; c = c_; }
    __device__ bool next(int i, Unit& u) const {
        const long L = (long)i * G + c; if (L >= nwg) return false;
        int wgid = (int)L; { const int q = nwg / NXCD, r = nwg % NXCD, xcd = wgid % NXCD, off = wgid / NXCD; wgid = (xcd < r ? xcd * (q + 1) : r * (q + 1) + (xcd - r) * q) + off; }
        const int nig = WGM * nN, gid = wgid / nig, fm = gid * WGM, gsz = (nM - fm) < WGM ? (nM - fm) : WGM;
        u.pm = fm + ((wgid % nig) % gsz); u.pn = (wgid % nig) / gsz; return true;
    }
};

template <bool ROWMAP> __device__ __forceinline__ int tile_row(int ai, int wr, int m, int fr) { return ROWMAP ? (wr * 128 + ai * 64 + m * 16 + fr) : (ai * 128 + wr * 64 + m * 16 + fr); }

template <class Epi, bool ALIGN_EPI>
__device__ __forceinline__ void gemm_phase(LAS unsigned char* lds, const Gemm g, const StaticOrder& S, const Epi& E) {
    constexpr bool ROWMAP = Epi::ROWMAP;
    int tid = threadIdx.x; asm volatile("" : "+v"(tid));
    const int wid = __builtin_amdgcn_readfirstlane(tid >> 6), lane = tid & 63, wr = wid >> 2, wc = wid & 3, fr = lane & 15, fq = lane >> 4;
    const int K = g.K, nt = K / BK, lda = g.lda;
    unsigned voffA[2], voffB[2];
#pragma unroll
    for (int i = 0; i < 2; ++i) { int R, C; stage_rc(tid * 16 + i * 8192, R, C); const int Rb = Epi::PERM ? ((R & ~31) + perm32(R & 31)) : R;
        const int Ra = ROWMAP ? (128 * (R >> 6) + (R & 63)) : R;
        voffA[i] = (unsigned)(Ra * lda + C) * 2u; voffB[i] = (unsigned)(Rb * K + C) * 2u; }
    const size_t kstep = (size_t)(BK * 2);
    const size_t hstepA = (size_t)(ROWMAP ? 64 : 128) * lda * 2, tstepA = (size_t)256 * lda * 2;
    const size_t hstepB = (size_t)HALF * K * 2, tstepB = 2 * hstepB;
    const unsigned ldsw = (unsigned)wid * 1024u;
    const int aoff = lds_byte(wr * 64 + fr, fq * 8), boff = lds_byte(wc * 32 + fr, fq * 8);
#define PG8_SA(b, h) (((b) * 2 + (h)) * HTB)
#define PG8_SB(b, h) ((4 + (b) * 2 + (h)) * HTB)
#define PG8_STAGE(bufoff, gbase, voff) do { _Pragma("unroll") for (int _i = 0; _i < 2; ++_i) \
        __builtin_amdgcn_global_load_lds((const unsigned*)((const char*)(gbase) + (voff)[_i]), (LAS unsigned*)(lds + (bufoff) + ldsw + _i * 8192), 16, 0, 0); } while (0)
#define PG8_LDA(dst, b, h) do { _Pragma("unroll") for (int m = 0; m < 4; ++m) _Pragma("unroll") for (int k = 0; k < 2; ++k) dst[m][k] = *(const LAS bf16x8*)(lds + PG8_SA(b, h) + aoff + m * 2048 + k * 1024); } while (0)
#define PG8_LDB(dst, b, h) do { _Pragma("unroll") for (int n = 0; n < 2; ++n) _Pragma("unroll") for (int k = 0; k < 2; ++k) dst[n][k] = *(const LAS bf16x8*)(lds + PG8_SB(b, h) + boff + n * 2048 + k * 1024); } while (0)
#define PG8_MMA(ai, bj, At, Bt) do { __builtin_amdgcn_s_setprio(1); _Pragma("unroll") for (int m = 0; m < 4; ++m) _Pragma("unroll") for (int n = 0; n < 2; ++n) _Pragma("unroll") for (int k = 0; k < 2; ++k) \
        acc[ai][bj][m][n] = __builtin_amdgcn_mfma_f32_16x16x32_bf16(Bt[n][k], At[m][k], acc[ai][bj][m][n], 0, 0, 0); __builtin_amdgcn_s_setprio(0); } while (0)
#define PG8_WAIT_V(n) asm volatile("s_waitcnt vmcnt(" #n ")" ::: "memory")
#define PG8_WAIT_L(n) asm volatile("s_waitcnt lgkmcnt(" #n ")" ::: "memory")
#define PG8_BAR __builtin_amdgcn_s_barrier()
#define PG8_SCHED __builtin_amdgcn_sched_barrier(0)
    Unit cur, nxt; int ui = 0;
    if (!S.next(0, cur)) return;
    f32x4 acc[2][2][4][2];
#pragma unroll
    for (int a = 0; a < 2; ++a)
#pragma unroll
        for (int b = 0; b < 2; ++b)
#pragma unroll
            for (int m = 0; m < 4; ++m)
#pragma unroll
                for (int n = 0; n < 2; ++n) acc[a][b][m][n] = (f32x4){0.f, 0.f, 0.f, 0.f};
    bf16x8 At[4][2], B0[2][2], B1[2][2];
    const char* cA = (const char*)g.A + (size_t)cur.pm * tstepA + (size_t)cur.pn * g.a_pn_off * 2; const char* cB = (const char*)g.Bt + (size_t)cur.pn * tstepB;
    PG8_STAGE(PG8_SB(0, 0), cB, voffB); PG8_STAGE(PG8_SB(0, 1), cB + hstepB, voffB); PG8_STAGE(PG8_SA(0, 0), cA, voffA); PG8_STAGE(PG8_SA(0, 1), cA + hstepA, voffA);
    if (wr == 1) PG8_BAR;
    PG8_WAIT_V(2); PG8_BAR;
    PG8_STAGE(PG8_SB(1, 0), cB + kstep, voffB); PG8_STAGE(PG8_SA(1, 0), cA + kstep, voffA); PG8_STAGE(PG8_SB(1, 1), cB + hstepB + kstep, voffB);
    PG8_WAIT_V(6); PG8_BAR;
    for (;;) {
        const bool has_next = S.next(ui + 1, nxt);
        const char* nA = has_next ? (const char*)g.A + (size_t)nxt.pm * tstepA + (size_t)nxt.pn * g.a_pn_off * 2 : cA; const char* nB = has_next ? (const char*)g.Bt + (size_t)nxt.pn * tstepB : cB;
        for (int t = 0; t < nt; t += 2) {
            const bool last = (t == nt - 2);
            const char* a1 = cA + (size_t)(t + 1) * kstep;
            const char* a2 = last ? nA : cA + (size_t)(t + 2) * kstep; const char* b2 = last ? nB : cB + (size_t)(t + 2) * kstep;
            const char* a3 = a2 + kstep; const char* b3 = b2 + kstep;
            PG8_LDB(B0, 0, 0); PG8_LDB(B1, 0, 1); PG8_SCHED; PG8_LDA(At, 0, 0); PG8_STAGE(PG8_SA(1, 1), a1 + hstepA, voffA);
            PG8_WAIT_V(8); PG8_WAIT_L(0); PG8_BAR; PG8_MMA(0, 0, At, B0); PG8_MMA(0, 1, At, B1); PG8_BAR; PG8_SCHED;
            PG8_LDA(At, 0, 1); PG8_STAGE(PG8_SB(0, 0), b2, voffB); PG8_STAGE(PG8_SB(0, 1), b2 + hstepB, voffB); PG8_STAGE(PG8_SA(0, 0), a2, voffA);
            PG8_WAIT_V(8); PG8_WAIT_L(0); PG8_BAR; PG8_MMA(1, 0, At, B0); PG8_MMA(1, 1, At, B1); PG8_BAR; PG8_SCHED;
            PG8_LDB(B0, 1, 0); PG8_LDB(B1, 1, 1); PG8_SCHED; PG8_LDA(At, 1, 0); PG8_STAGE(PG8_SA(0, 1), a2 + hstepA, voffA);
            PG8_WAIT_V(8); PG8_WAIT_L(0); PG8_BAR; PG8_MMA(0, 0, At, B0); PG8_MMA(0, 1, At, B1); PG8_BAR; PG8_SCHED;
            PG8_LDA(At, 1, 1); PG8_STAGE(PG8_SB(1, 0), b3, voffB); PG8_STAGE(PG8_SB(1, 1), b3 + hstepB, voffB); PG8_STAGE(PG8_SA(1, 0), a3, voffA);
            PG8_WAIT_V(8); PG8_WAIT_L(0); PG8_BAR; PG8_MMA(1, 0, At, B0); PG8_MMA(1, 1, At, B1); PG8_BAR; PG8_SCHED;
        }
        if constexpr (ALIGN_EPI) { if (wr == 0) PG8_BAR; }
        { int efr = fr, efq = fq; asm volatile("" : "+v"(efr), "+v"(efq)); E(acc, cur, wr, wc, efr, efq); }
        if (!has_next) break;
#pragma unroll
        for (int a = 0; a < 2; ++a)
#pragma unroll
            for (int b = 0; b < 2; ++b)
#pragma unroll
                for (int m = 0; m < 4; ++m)
#pragma unroll
                    for (int n = 0; n < 2; ++n) acc[a][b][m][n] = (f32x4){0.f, 0.f, 0.f, 0.f};
        cur = nxt; cA = nA; cB = nB; ++ui;
        if constexpr (ALIGN_EPI) { if (wr == 1) PG8_BAR; }
    }
    PG8_WAIT_V(0);
    if constexpr (!ALIGN_EPI) { if (wr == 0) PG8_BAR; }
    PG8_BAR;
#undef PG8_SA
#undef PG8_SB
#undef PG8_STAGE
#undef PG8_LDA
#undef PG8_LDB
#undef PG8_MMA
#undef PG8_WAIT_V
#undef PG8_WAIT_L
#undef PG8_BAR
#undef PG8_SCHED
}
}
using pg8::Unit;
typedef f32x4 AccT[2][2][4][2];

struct EpiG1 {
    static constexpr bool PERM = true, ROWMAP = false;
    bf16_t *U, *P, *BG, *SA, *SB; float* out;
    __device__ __forceinline__ void operator()(const AccT& acc, const Unit& u, int wr, int wc, int fr, int fq) const {
        const int pn = u.pn, c8 = wc * 32 + 8 * fq;
        const bool st_tile = ((u.pm & 7) == 7) || u.pm == 64;
        const int row0 = u.pm * 256 + wr * 64 + fr;
        if (pn < 2 || (pn >= 6 && pn < 8)) {
            bf16_t* base = (pn < 2 ? U + pn * 256 : BG + (pn - 6) * 256) + c8;
#pragma unroll
            for (int ai = 0; ai < 2; ++ai)
#pragma unroll
                for (int m = 0; m < 4; ++m) { bf16_t* rp = base + (size_t)(row0 + ai * 128 + m * 16) * PW;
#pragma unroll
                    for (int bj = 0; bj < 2; ++bj) *(u32x4*)(rp + bj * 128) = pack8(acc[ai][bj][m][0], acc[ai][bj][m][1]);
                    asm volatile("" ::: "memory"); }
            if (pn < 2 && st_tile) {
#pragma unroll
                for (int ai = 0; ai < 2; ++ai)
#pragma unroll
                    for (int m = 0; m < 4; ++m) { const int row = row0 + ai * 128 + m * 16; float* dst = nullptr;
                        if (row < R_SAMP) { const int s = row & 2047; if (s >= 2033) dst = out + O_NSPP + ((size_t)((row >> 11) * 15 + (s - 2033))) * PW; }
                        else if (row < R_META) dst = out + O_NSPS + ((size_t)((row - R_SAMP) * 15 + 14)) * PW;
                        if (dst) { dst += pn * 256 + c8;
#pragma unroll
                            for (int bj = 0; bj < 2; ++bj) { *(f32x4*)(dst + bj * 128) = acc[ai][bj][m][0]; *(f32x4*)(dst + bj * 128 + 4) = acc[ai][bj][m][1]; } }
                        asm volatile("" ::: "memory"); }
            }
        } else if (pn < 6) {
            const int col = (pn - 2) * 128 + c8;
#pragma unroll
            for (int ai = 0; ai < 2; ++ai)
#pragma unroll
                for (int m = 0; m < 4; ++m) { const int row = row0 + ai * 128 + m * 16;
                    const f32x4 p0 = acc[ai][0][m][0] * acc[ai][1][m][0], p1 = acc[ai][0][m][1] * acc[ai][1][m][1];
                    *(u32x4*)(P + (size_t)row * CW + col) = pack8(p0, p1);
                    if (st_tile) { float* dst = nullptr;
                        if (row < R_SAMP) { const int s = row & 2047; if (s >= 2046) dst = out + O_NSCP + ((size_t)((row >> 11) * 2 + (s - 2046))) * CW; }
                        else if (row < R_META) dst = out + O_NSCS + ((size_t)((row - R_SAMP) * 2 + 1)) * CW;
                        if (dst) { *(f32x4*)(dst + col) = p0; *(f32x4*)(dst + col + 4) = p1; } }
                    asm volatile("" ::: "memory"); }
        } else {
            bf16_t* base = (pn < 12 ? SA : SB) + ((pn - 8) & 3) * 256 + c8;
#pragma unroll
            for (int ai = 0; ai < 2; ++ai)
#pragma unroll
                for (int m = 0; m < 4; ++m) { bf16_t* rp = base + (size_t)(row0 + ai * 128 + m * 16) * D;
#pragma unroll
                    for (int bj = 0; bj < 2; ++bj) { f32x4 a = acc[ai][bj][m][0], b = acc[ai][bj][m][1];
#pragma unroll
                        for (int e = 0; e < 4; ++e) { a[e] = sigmoidf_(a[e]); b[e] = sigmoidf_(b[e]); }
                        *(u32x4*)(rp + bj * 128) = pack8(a, b); }
                    asm volatile("" ::: "memory"); }
        }
    }
};
template <int MODE> struct EpiMix {
    static constexpr bool PERM = true, ROWMAP = false;
    bf16_t* SA; const bf16_t* SB;
    __device__ __forceinline__ void operator()(const AccT& acc, const Unit& u, int wr, int wc, int fr, int fq) const {
        const int c8 = u.pn * 256 + wc * 32 + 8 * fq;
#pragma unroll
        for (int ai = 0; ai < 2; ++ai)
#pragma unroll
            for (int m = 0; m < 4; ++m) {
                const size_t off = (size_t)(u.pm * 256 + pg8::tile_row<false>(ai, wr, m, fr)) * D + c8;
#pragma unroll
                for (int bj = 0; bj < 2; ++bj) {
                    f32x4 a0, a1; unpack8(*(const u32x4*)(SA + off + bj * 128), a0, a1);
                    if (MODE == 0) { a0 = a0 * acc[ai][bj][m][0]; a1 = a1 * acc[ai][bj][m][1]; }
                    else { f32x4 b0, b1; unpack8(*(const u32x4*)(SB + off + bj * 128), b0, b1); a0 = a0 + b0 * acc[ai][bj][m][0]; a1 = a1 + b1 * acc[ai][bj][m][1]; }
                    *(u32x4*)(SA + off + bj * 128) = pack8(a0, a1);
                }
                asm volatile("" ::: "memory");
            }
    }
};
struct EpiF32 {
    static constexpr bool PERM = false, ROWMAP = false;
    float* C; int ldc;
    __device__ __forceinline__ void operator()(const AccT& acc, const Unit& u, int wr, int wc, int fr, int fq) const {
        const int col0 = u.pn * 256 + wc * 32 + 4 * fq;
#pragma unroll
        for (int ai = 0; ai < 2; ++ai)
#pragma unroll
            for (int m = 0; m < 4; ++m) { float* rowp = C + (size_t)(u.pm * 256 + pg8::tile_row<false>(ai, wr, m, fr)) * ldc + col0;
#pragma unroll
                for (int bj = 0; bj < 2; ++bj)
#pragma unroll
                    for (int n = 0; n < 2; ++n) *(f32x4*)(rowp + bj * 128 + n * 16) = acc[ai][bj][m][n]; }
    }
};
template <int N> __device__ __forceinline__ float ror16(float v) { return __builtin_bit_cast(float, __builtin_amdgcn_update_dpp(0, __builtin_bit_cast(int, v), 0x120 + N, 0xf, 0xf, false)); }
struct EpiG5 {
    static constexpr bool PERM = true, ROWMAP = true;
    bf16_t* ACT; float* HALO; float* UPR; const float* wfc;
    __device__ __forceinline__ void operator()(AccT& acc, const Unit& u, int wr, int wc, int fr, int fq) const {
        const int c8 = wc * 32 + 8 * fq, pcol = u.pn * 256 + c8;
        if (u.pm == 64) {
#pragma unroll
            for (int ai = 0; ai < 2; ++ai)
#pragma unroll
                for (int m = 0; m < 4; ++m) { float* rowp = UPR + (size_t)pg8::tile_row<true>(ai, wr, m, fr) * NUP + pcol;
#pragma unroll
                    for (int bj = 0; bj < 2; ++bj)
#pragma unroll
                        for (int n = 0; n < 2; ++n) *(f32x4*)(rowp + bj * 128 + 4 * n) = acc[ai][bj][m][n];
                    asm volatile("" ::: "memory"); }
        }
        {
            const int blk = u.pm * 2 + wr;
            if (fr < 2) { float* hp = HALO + ((size_t)blk * 4 + fr) * NUP + pcol;
#pragma unroll
                for (int bj = 0; bj < 2; ++bj)
#pragma unroll
                    for (int n = 0; n < 2; ++n) *(f32x4*)(hp + bj * 128 + 4 * n) = acc[0][bj][0][n]; }
            if (fr >= 14) { float* hp = HALO + ((size_t)blk * 4 + (fr - 12)) * NUP + pcol;
#pragma unroll
                for (int bj = 0; bj < 2; ++bj)
#pragma unroll
                    for (int n = 0; n < 2; ++n) *(f32x4*)(hp + bj * 128 + 4 * n) = acc[1][bj][3][n]; }
        }
        const bool f0 = (fr == 0), f01 = (fr < 2);
        const int rowb = u.pm * 256 + wr * 128 + fr;
#pragma unroll
        for (int n = 0; n < 2; ++n) {
            f32x4 w[3][2];
#pragma unroll
            for (int k = 0; k < 3; ++k)
#pragma unroll
                for (int bj = 0; bj < 2; ++bj) w[k][bj] = *(const f32x4*)(wfc + (size_t)k * NUP + pcol + bj * 128 + 4 * n);
#pragma unroll
            for (int q = 7; q >= 0; --q) {
                const int ai = q >> 2, m = q & 3, aip = (q - 1) >> 2, mp = (q - 1) & 3;
                f32x4 o[2];
#pragma unroll
                for (int bj = 0; bj < 2; ++bj)
#pragma unroll
                    for (int e = 0; e < 4; ++e) {
                        const float v = acc[ai][bj][m][n][e];
                        const float vp = q > 0 ? acc[aip & 1][bj][mp][n][e] : 0.f;
                        const float r1 = ror16<1>(v), r2 = ror16<2>(v), r1p = ror16<1>(vp), r2p = ror16<2>(vp);
                        const float p1 = f0 ? r1p : r1, p2 = f01 ? r2p : r2;
                        o[bj][e] = w[0][bj][e] * p2 + w[1][bj][e] * p1 + w[2][bj][e] * v;
                    }
                f32x4 a;
#pragma unroll
                for (int e = 0; e < 4; ++e) a[e] = o[0][e] * sigmoidf_(o[0][e]) * o[1][e];
                u32x2 pk; pk.x = cvt_pk_bf16(a[0], a[1]); pk.y = cvt_pk_bf16(a[2], a[3]);
                if (!(q == 0 && f01)) *(u32x2*)(ACT + (size_t)(rowb + q * 16) * DFF + u.pn * 128 + c8 + 4 * n) = pk;
                asm volatile("" ::: "memory"); __builtin_amdgcn_sched_barrier(0);
            }
        }
    }
};

struct Args { const float* in[19]; float* out; unsigned char* ws; };

__device__ __forceinline__ void transpose_item(const float* W, int K, int N, bf16_t* WT, int dst_row0, int src_col0, int k0, const float* ks, const float* ns, LAS float* scr, int lane) {
#pragma unroll 8
    for (int i = 0; i < 32; ++i) { const int kk = 2 * i + (lane >> 5); float v = W[(size_t)(k0 + kk) * N + src_col0 + (lane & 31)]; if (ks) v *= ks[k0 + kk]; scr[kk * 33 + (lane & 31)] = v; }
    LDS_WAIT(); asm volatile("" ::: "memory");
    const int c = lane & 7;
#pragma unroll
    for (int j = 0; j < 4; ++j) { const int n = (lane >> 3) + 8 * j; const LAS float* s = scr + (8 * c) * 33 + n; const float sc = ns ? ns[dst_row0 + n] : 1.f;
        u32x4 o; o.x = cvt_pk_bf16(s[0 * 33] * sc, s[1 * 33] * sc); o.y = cvt_pk_bf16(s[2 * 33] * sc, s[3 * 33] * sc); o.z = cvt_pk_bf16(s[4 * 33] * sc, s[5 * 33] * sc); o.w = cvt_pk_bf16(s[6 * 33] * sc, s[7 * 33] * sc);
        *(u32x4*)(WT + (size_t)(dst_row0 + n) * K + k0 + 8 * c) = o; }
    LDS_WAIT(); asm volatile("" ::: "memory");
}
__device__ __forceinline__ int win_src(int d) { if (d < 4) return 128 * d; if (d < 12) { const int t = (d - 4) >> 1; return ((d - 4) & 1) ? 1536 + 128 * t : 512 + 128 * t; } if (d < 16) return 1024 + (d - 12) * 128; return 2048 + (d - 16) * 128; }
__device__ __forceinline__ int wup_src(int d) { return (d & 1) ? DFF + 128 * (d >> 1) : 128 * (d >> 1); }
__device__ __forceinline__ int up_perm_of(int c) { return c < DFF ? ((c >> 7) * 256 + (c & 127)) : (((c - DFF) >> 7) * 256 + 128 + ((c - DFF) & 127)); }

__device__ __forceinline__ const float* x_row_ptr(const Args& a, int r) {
    if (r < R_SAMP) return a.in[0] + (size_t)r * D;
    if (r < R_META) return a.in[1] + (size_t)(r - R_SAMP) * D;
    if (r < R_PAD) return a.in[5] + (size_t)(r - R_META) * D;
    return nullptr;
}

__global__ void __launch_bounds__(NWAVES * 64, 2) fwd_kernel(Args args) {
    extern __shared__ __attribute__((aligned(16))) unsigned char lds_raw[];
    LAS unsigned char* lds = (LAS unsigned char*)lds_raw;
    volatile LAS unsigned* MISC = (volatile LAS unsigned*)(lds + MISC_OFF);
    const int G = gridDim.x; const int bx = blockIdx.x; const int vcu = (G % 8 == 0) ? (bx % 8) * (G / 8) + bx / 8 : bx;
    const int NGW = G * NWAVES;
#define PHASE_IDS int tid = threadIdx.x; asm volatile("" : "+v"(tid)); const int lane = tid & 63, wave = __builtin_amdgcn_readfirstlane(tid >> 6); const int gw = vcu * NWAVES + wave; (void)gw; (void)lane;
    unsigned char* ws = args.ws; float* out = args.out;
    unsigned* ctl = (unsigned*)(ws + WS_CTL);
    { PHASE_IDS for (int u = tid; u < (LDS_BYTES - LDSCTL_OFF) / 4; u += NWAVES * 64) ((LAS unsigned*)(lds + LDSCTL_OFF))[u] = 0u; }
    __syncthreads();
    XcdBarrier bar = xcd_barrier_post(ctl + CW_BAR, MISC + 8);

    bf16_t* WinT = (bf16_t*)(ws + WS_WIN); bf16_t* WpT = (bf16_t*)(ws + WS_WP); bf16_t* WcoT = (bf16_t*)(ws + WS_WCO); bf16_t* WoT = (bf16_t*)(ws + WS_WO);
    bf16_t* WupT = (bf16_t*)(ws + WS_WUP); bf16_t* WdT = (bf16_t*)(ws + WS_WD); float* WFC = (float*)(ws + WS_WFC);
    bf16_t* HB = (bf16_t*)(ws + WS_HB);
    bf16_t* Ub = (bf16_t*)(ws + WS_U); bf16_t* Pb = (bf16_t*)(ws + WS_P); bf16_t* BGb = (bf16_t*)(ws + WS_BG); bf16_t* POOLED = (bf16_t*)(ws + WS_POOLED); bf16_t* BGCV = (bf16_t*)(ws + WS_BGCV);
    bf16_t* SAb = (bf16_t*)(ws + WS_SA); bf16_t* SBb = (bf16_t*)(ws + WS_SB);
    float* Ob = (float*)(ws + WS_O); float* X1R = (float*)(ws + WS_X1R); bf16_t* ACT = (bf16_t*)(ws + WS_ACT); float* HALO = (float*)(ws + WS_HALO); float* UPR = (float*)(ws + WS_UPR); float* Yb = (float*)(ws + WS_Y);

    {
        PHASE_IDS
        LAS float* scr = (LAS float*)(lds + wave * 16384);
        constexpr int I_IN = 16 * 128, I_P = 4 * 2 * 8, I_CO = 8 * 32, I_O = 16 * 32, I_UP = 16 * 176, I_D = 44 * 32;
        constexpr int NITEMS = I_IN + I_P + I_CO + I_O + I_UP + I_D;
        for (int it = gw; it < NITEMS; it += NGW) {
            int r = it;
            if (r < I_IN) { const int kb = r / 128, nb = r % 128; transpose_item(args.in[6], D, NIN, WinT, nb * 32, win_src(nb >> 2) + (nb & 3) * 32, kb * 64, args.in[15], nullptr, scr, lane); continue; } r -= I_IN;
            if (r < I_P) { const int g = r / 16, kb = (r % 16) / 8, nb = r % 8; transpose_item(args.in[7] + (size_t)g * 128 * 256, 128, 256, WpT + (size_t)g * 256 * 128, nb * 32, nb * 32, kb * 64, nullptr, args.in[8] + g * 256, scr, lane); continue; } r -= I_P;
            if (r < I_CO) { const int kb = r / 32, nb = r % 32; transpose_item(args.in[10], CW, D, WcoT, nb * 32, nb * 32, kb * 64, nullptr, nullptr, scr, lane); continue; } r -= I_CO;
            if (r < I_O) { const int kb = r / 32, nb = r % 32; transpose_item(args.in[11], D, D, WoT, nb * 32, nb * 32, kb * 64, nullptr, nullptr, scr, lane); continue; } r -= I_O;
            if (r < I_UP) { const int kb = r / 176, nb = r % 176; transpose_item(args.in[12], D, NUP, WupT, nb * 32, wup_src(nb >> 2) + (nb & 3) * 32, kb * 64, args.in[17], nullptr, scr, lane); continue; } r -= I_UP;
            { const int kb = r / 32, nb = r % 32; transpose_item(args.in[14], DFF, D, WdT, nb * 32, nb * 32, kb * 64, nullptr, nullptr, scr, lane); }
        }
        for (int i = gw * 64 + lane; i < 3 * NUP; i += NGW * 64) { const int k = i / NUP, c = i % NUP; WFC[k * NUP + up_perm_of(c)] = args.in[13][i]; }
        for (int i = gw * 64 + lane; i < DEC * 14 * PW; i += NGW * 64) { const int b = i / (14 * PW), rem = i % (14 * PW); out[O_NSPS + (size_t)b * 15 * PW + rem] = args.in[2][(size_t)b * 15 * PW + PW + rem]; }
        for (int i = gw * 64 + lane; i < DEC * CW; i += NGW * 64) { const int b = i / CW, c = i % CW; out[O_NSCS + (size_t)b * 2 * CW + c] = args.in[3][(size_t)b * 2 * CW + CW + c]; }
        for (int i = gw * 64 + lane; i < DEC * NUP; i += NGW * 64) { const int b = i / NUP, c = i % NUP; out[O_NSFS + (size_t)b * 2 * NUP + c] = args.in[4][(size_t)b * 2 * NUP + NUP + c]; }
        for (int r = gw; r < M; r += NGW) {
            const float* xr = x_row_ptr(args, r);
            unsigned long long* o8 = (unsigned long long*)(HB + (size_t)r * D) + lane;
            if (!xr) {
#pragma unroll
                for (int j = 0; j < 4; ++j) o8[64 * j] = 0ull;
                continue; }
            f32x4 v[4]; float s2 = 0.f;
#pragma unroll
            for (int j = 0; j < 4; ++j) { v[j] = ((const f32x4*)xr)[lane + 64 * j]; s2 += (v[j].x * v[j].x + v[j].y * v[j].y) + (v[j].z * v[j].z + v[j].w * v[j].w); }
            const float rstd = 1.0f / sqrtf(wave_sum(s2) * (1.f / D) + EPS);
#pragma unroll
            for (int j = 0; j < 4; ++j) o8[64 * j] = (unsigned long long)cvt_pk_bf16(v[j].x * rstd, v[j].y * rstd) | ((unsigned long long)cvt_pk_bf16(v[j].z * rstd, v[j].w * rstd) << 32);
        }
    }
    xcd_barrier(bar);

    {
        pg8::Gemm g{HB, WinT, D, D, NTILE, NIN / 256, 0}; pg8::StaticOrder S; S.init(NTILE, NIN / 256, G, bx);
        EpiG1 E{Ub, Pb, BGb, SAb, SBb, out};
        pg8::gemm_phase<EpiG1, true>(lds, g, S, E);
    }
    xcd_barrier(bar);

    {
        PHASE_IDS
        const float* st_pool = args.in[2]; const float* st_conv = args.in[3]; const float* wconv = args.in[9];
        const int c0 = lane * 8; const int grp = lane >> 4; const int w = 2 << grp;
        f32x4 wc0a = *(const f32x4*)(wconv + c0), wc0b = *(const f32x4*)(wconv + c0 + 4), wc1a = *(const f32x4*)(wconv + CW + c0), wc1b = *(const f32x4*)(wconv + CW + c0 + 4), wc2a = *(const f32x4*)(wconv + 2 * CW + c0), wc2b = *(const f32x4*)(wconv + 2 * CW + c0 + 4);
        for (int r = gw; r < M; r += NGW) {
            f32x4 s0 = {0.f, 0.f, 0.f, 0.f}, s1 = s0, u0, u1;
            unpack8(*(const u32x4*)(Ub + (size_t)r * PW + c0), u0, u1); s0 = u0; s1 = u1;
            float cnt = (float)w;
            if (r >= R_META) { const int t = r - R_META; if (t + 1 < w) cnt = (float)(t + 1); }
            for (int j = 1; j < w; ++j) {
                f32x4 a0, a1;
                if (r < R_SAMP) { const int s = r & 2047; const int pr = (s >= j) ? (r - j) : (R_META + 16 + s - j); unpack8(*(const u32x4*)(Ub + (size_t)pr * PW + c0), a0, a1); }
                else if (r < R_META) { const float* sp = st_pool + ((size_t)(r - R_SAMP) * 15 + (15 - j)) * PW + c0; a0 = *(const f32x4*)sp; a1 = *(const f32x4*)(sp + 4); }
                else { if (r - R_META >= j) unpack8(*(const u32x4*)(Ub + (size_t)(r - j) * PW + c0), a0, a1); else { a0 = (f32x4){0.f, 0.f, 0.f, 0.f}; a1 = a0; } }
                s0 += a0; s1 += a1;
            }
            const float ic = 1.0f / cnt;
            *(u32x4*)(POOLED + (size_t)r * PW + c0) = pack8(s0 * ic - u0, s1 * ic - u1);
            f32x4 p0, p1, q0, q1, t0, t1, b0, b1;
            unpack8(*(const u32x4*)(Pb + (size_t)r * CW + c0), p0, p1);
#pragma unroll
            for (int j = 1; j <= 2; ++j) {
                f32x4 a0, a1;
                if (r < R_SAMP) { const int s = r & 2047; const int pr = (s >= j) ? (r - j) : (R_META + 16 + s - j); unpack8(*(const u32x4*)(Pb + (size_t)pr * CW + c0), a0, a1); }
                else if (r < R_META) { const float* sp = st_conv + ((size_t)(r - R_SAMP) * 2 + (2 - j)) * CW + c0; a0 = *(const f32x4*)sp; a1 = *(const f32x4*)(sp + 4); }
                else { if (r - R_META >= j) unpack8(*(const u32x4*)(Pb + (size_t)(r - j) * CW + c0), a0, a1); else { a0 = (f32x4){0.f, 0.f, 0.f, 0.f}; a1 = a0; } }
                if (j == 1) { q0 = a0; q1 = a1; } else { t0 = a0; t1 = a1; }
            }
            unpack8(*(const u32x4*)(BGb + (size_t)r * CW + c0), b0, b1);
            const f32x4 cv0 = wc0a * t0 + wc1a * q0 + wc2a * p0, cv1 = wc0b * t1 + wc1b * q1 + wc2b * p1;
            *(u32x4*)(BGCV + (size_t)r * CW + c0) = pack8(b0 * cv0, b1 * cv1);
        }
    }
    xcd_barrier(bar);

    {
        pg8::Gemm g{POOLED, WpT, PW, 128, NTILE, 4, 128}; pg8::StaticOrder S; S.init(NTILE, 4, G, bx);
        EpiMix<0> E{SAb, SBb};
        pg8::gemm_phase<EpiMix<0>, true>(lds, g, S, E);
    }
    xcd_barrier(bar);
    {
        pg8::Gemm g{BGCV, WcoT, CW, CW, NTILE, 4, 0}; pg8::StaticOrder S; S.init(NTILE, 4, G, bx);
        EpiMix<1> E{SAb, SBb};
        pg8::gemm_phase<EpiMix<1>, true>(lds, g, S, E);
    }
    xcd_barrier(bar);
    {
        pg8::Gemm g{SAb, WoT, D, D, NTILE, 4, 0}; pg8::StaticOrder S; S.init(NTILE, 4, G, bx);
        EpiF32 E{Ob, D};
        pg8::gemm_phase<EpiF32, true>(lds, g, S, E);
    }
    xcd_barrier(bar);
    {
        PHASE_IDS
        const float* gpm = args.in[16];
        f32x4 gv[4];
#pragma unroll
        for (int j = 0; j < 4; ++j) gv[j] = ((const f32x4*)gpm)[lane + 64 * j];
        for (int r = gw; r < M; r += NGW) {
            const float* xr = x_row_ptr(args, r);
            unsigned long long* o8 = (unsigned long long*)(HB + (size_t)r * D) + lane;
            if (!xr) {
#pragma unroll
                for (int j = 0; j < 4; ++j) o8[64 * j] = 0ull;
                continue; }
            f32x4 o[4], x[4]; float s2 = 0.f;
#pragma unroll
            for (int j = 0; j < 4; ++j) { o[j] = ((const f32x4*)(Ob + (size_t)r * D))[lane + 64 * j]; x[j] = ((const f32x4*)xr)[lane + 64 * j]; s2 += (o[j].x * o[j].x + o[j].y * o[j].y) + (o[j].z * o[j].z + o[j].w * o[j].w); }
            const float rstd = 1.0f / sqrtf(wave_sum(s2) * (1.f / D) + EPS);
            float* x1p = (r < R_META) ? out + (size_t)r * D : X1R + (size_t)(r - R_META) * D;
            float t2 = 0.f;
#pragma unroll
            for (int j = 0; j < 4; ++j) { x[j] = x[j] + o[j] * rstd * gv[j]; ((f32x4*)x1p)[lane + 64 * j] = x[j]; t2 += (x[j].x * x[j].x + x[j].y * x[j].y) + (x[j].z * x[j].z + x[j].w * x[j].w); }
            const float rstd2 = 1.0f / sqrtf(wave_sum(t2) * (1.f / D) + EPS);
#pragma unroll
            for (int j = 0; j < 4; ++j) o8[64 * j] = (unsigned long long)cvt_pk_bf16(x[j].x * rstd2, x[j].y * rstd2) | ((unsigned long long)cvt_pk_bf16(x[j].z * rstd2, x[j].w * rstd2) << 32);
        }
    }
    xcd_barrier(bar);
    {
        pg8::Gemm g{HB, WupT, D, D, NTILE, NUP / 256, 0}; pg8::StaticOrder S; S.init(NTILE, NUP / 256, G, bx);
        EpiG5 E{ACT, HALO, UPR, WFC};
        pg8::gemm_phase<EpiG5, true>(lds, g, S, E);
    }
    xcd_barrier(bar);
    {
        PHASE_IDS
        const float* wf = args.in[13]; const float* st_ffn = args.in[4];
        const int gt = gw * 64 + lane, NT = NGW * 64;
        for (int it = gt; it < 128 * 2 * (DFF / 4); it += NT) {
            const int c = (it % (DFF / 4)) * 4, bi = it / (DFF / 4), i = bi & 1, B = bi >> 1;
            const int pg = (c >> 7) * 256 + (c & 127);
            const float* cur = HALO + ((size_t)B * 4 + i) * NUP;
            const float* p1; const float* p2;
            if ((B & 15) == 0) { p1 = (i == 0) ? UPR + (size_t)(128 + 15) * NUP : cur - NUP; p2 = (i == 0) ? UPR + (size_t)(128 + 14) * NUP : UPR + (size_t)(128 + 15) * NUP; }
            else { const float* prv = HALO + ((size_t)(B - 1) * 4) * NUP; p1 = (i == 0) ? prv + 3 * NUP : cur - NUP; p2 = (i == 0) ? prv + 2 * NUP : prv + 3 * NUP; }
            const f32x4 g0 = *(const f32x4*)(cur + pg), g1 = *(const f32x4*)(p1 + pg), g2 = *(const f32x4*)(p2 + pg);
            const f32x4 v0 = *(const f32x4*)(cur + pg + 128), v1 = *(const f32x4*)(p1 + pg + 128), v2 = *(const f32x4*)(p2 + pg + 128);
            const f32x4 wg0 = *(const f32x4*)(wf + c), wg1 = *(const f32x4*)(wf + NUP + c), wg2 = *(const f32x4*)(wf + 2 * NUP + c);
            const f32x4 wv0 = *(const f32x4*)(wf + DFF + c), wv1 = *(const f32x4*)(wf + NUP + DFF + c), wv2 = *(const f32x4*)(wf + 2 * NUP + DFF + c);
            const f32x4 gg = wg0 * g2 + wg1 * g1 + wg2 * g0, vv = wv0 * v2 + wv1 * v1 + wv2 * v0;
            f32x4 a;
#pragma unroll
            for (int e = 0; e < 4; ++e) a[e] = gg[e] * sigmoidf_(gg[e]) * vv[e];
            u32x2 o; o.x = cvt_pk_bf16(a[0], a[1]); o.y = cvt_pk_bf16(a[2], a[3]);
            *(u32x2*)(ACT + (size_t)(B * 128 + i) * DFF + c) = o;
        }
        for (int it = gt; it < 144 * (DFF / 4); it += NT) {
            const int c = (it % (DFF / 4)) * 4, rr = it / (DFF / 4);
            const int pg = (c >> 7) * 256 + (c & 127);
            const float* cur = UPR + (size_t)rr * NUP;
            f32x4 g1, g2, v1, v2;
            if (rr < 128) { const float* s1 = st_ffn + ((size_t)rr * 2 + 1) * NUP; const float* s0 = st_ffn + ((size_t)rr * 2) * NUP;
                g1 = *(const f32x4*)(s1 + c); g2 = *(const f32x4*)(s0 + c); v1 = *(const f32x4*)(s1 + DFF + c); v2 = *(const f32x4*)(s0 + DFF + c); }
            else { const int t = rr - 128; const f32x4 z = {0.f, 0.f, 0.f, 0.f};
                g1 = t >= 1 ? *(const f32x4*)(cur - NUP + pg) : z; v1 = t >= 1 ? *(const f32x4*)(cur - NUP + pg + 128) : z;
                g2 = t >= 2 ? *(const f32x4*)(cur - 2 * NUP + pg) : z; v2 = t >= 2 ? *(const f32x4*)(cur - 2 * NUP + pg + 128) : z; }
            const f32x4 g0 = *(const f32x4*)(cur + pg), v0 = *(const f32x4*)(cur + pg + 128);
            const f32x4 wg0 = *(const f32x4*)(wf + c), wg1 = *(const f32x4*)(wf + NUP + c), wg2 = *(const f32x4*)(wf + 2 * NUP + c);
            const f32x4 wv0 = *(const f32x4*)(wf + DFF + c), wv1 = *(const f32x4*)(wf + NUP + DFF + c), wv2 = *(const f32x4*)(wf + 2 * NUP + DFF + c);
            const f32x4 gg = wg0 * g2 + wg1 * g1 + wg2 * g0, vv = wv0 * v2 + wv1 * v1 + wv2 * v0;
            f32x4 a;
#pragma unroll
            for (int e = 0; e < 4; ++e) a[e] = gg[e] * sigmoidf_(gg[e]) * vv[e];
            u32x2 o; o.x = cvt_pk_bf16(a[0], a[1]); o.y = cvt_pk_bf16(a[2], a[3]);
            *(u32x2*)(ACT + (size_t)(R_SAMP + rr) * DFF + c) = o;
        }
        for (int it = gt; it < (M - R_PAD) * (DFF / 8); it += NT) ((u32x4*)(ACT + (size_t)R_PAD * DFF))[it] = (u32x4){0u, 0u, 0u, 0u};
        for (int it = gt; it < NB * 2 * NUP; it += NT) { const int c = it % NUP, bi = it / NUP, i = bi & 1, b = bi >> 1;
            out[O_NSFP + it] = HALO[((size_t)(b * 16 + 15) * 4 + 2 + i) * NUP + up_perm_of(c)]; }
        for (int it = gt; it < DEC * NUP; it += NT) { const int c = it % NUP, b = it / NUP; out[O_NSFS + ((size_t)b * 2 + 1) * NUP + c] = UPR[(size_t)b * NUP + up_perm_of(c)]; }
    }
    xcd_barrier(bar);
    {
        pg8::Gemm g{ACT, WdT, DFF, DFF, NTILE, 4, 0}; pg8::StaticOrder S; S.init(NTILE, 4, G, bx);
        EpiF32 E{Yb, D};
        pg8::gemm_phase<EpiF32, true>(lds, g, S, E);
    }
    xcd_barrier(bar);
    {
        PHASE_IDS
        const float* gpf = args.in[18];
        f32x4 gv[4];
#pragma unroll
        for (int j = 0; j < 4; ++j) gv[j] = ((const f32x4*)gpf)[lane + 64 * j];
        const bool bad = xb_ld(&bar.bar[XB_TMO]) != 0u;
        for (int r = gw; r < R_META; r += NGW) {
            f32x4 y[4], x[4]; float s2 = 0.f;
            float* op = out + (size_t)r * D;
#pragma unroll
            for (int j = 0; j < 4; ++j) { y[j] = ((const f32x4*)(Yb + (size_t)r * D))[lane + 64 * j]; x[j] = ((const f32x4*)op)[lane + 64 * j]; s2 += (y[j].x * y[j].x + y[j].y * y[j].y) + (y[j].z * y[j].z + y[j].w * y[j].w); }
            const float rstd = bad ? __builtin_nanf("") : 1.0f / sqrtf(wave_sum(s2) * (1.f / D) + EPS);
#pragma unroll
            for (int j = 0; j < 4; ++j) ((f32x4*)op)[lane + 64 * j] = x[j] + y[j] * rstd * gv[j];
        }
    }
}

extern "C" void kernel_launch(void* const* d_in, const int* in_sizes, int n_in, void* d_out, int out_size, void* d_ws, size_t ws_size, hipStream_t stream) {
    static int grid = 0;
    if (grid == 0) {
        if (n_in != 19 || ws_size < WS_END) { fprintf(stderr, "kernel_launch: unexpected n_in %d / ws %zu\n", n_in, ws_size); grid = -1; return; }
        int dev = 0, cus = 0, per_cu = 0;
        if (hipGetDevice(&dev) != hipSuccess || hipDeviceGetAttribute(&cus, hipDeviceAttributeMultiprocessorCount, dev) != hipSuccess) { grid = -1; return; }
        if (hipFuncSetAttribute((const void*)fwd_kernel, hipFuncAttributeMaxDynamicSharedMemorySize, LDS_BYTES) != hipSuccess) { fprintf(stderr, "kernel_launch: hipFuncSetAttribute failed\n"); grid = -1; return; }
        if (hipOccupancyMaxActiveBlocksPerMultiprocessor(&per_cu, (const void*)fwd_kernel, NWAVES * 64, LDS_BYTES) != hipSuccess || per_cu < 1) { fprintf(stderr, "kernel_launch: occupancy query says %d\n", per_cu); per_cu = 1; }
        (void)hipGetLastError();
        grid = cus;
    }
    if (grid < 0) return;
    (void)hipMemsetAsync((char*)d_ws + WS_CTL, 0, CTL_ZERO_BYTES, stream);
    Args a{};
    for (int i = 0; i < 19; ++i) a.in[i] = (const float*)d_in[i];
    a.out = (float*)d_out; a.ws = (unsigned char*)d_ws;
    hipLaunchKernelGGL(fwd_kernel, dim3(grid), dim3(NWAVES * 64), LDS_BYTES, stream, a);
}
```
